# Optimizing an MI355X kernel written in HIP

```python
import jax, jax.numpy as jnp
from jax import lax
import numpy as np

D_MODEL = 1024
BATCH = 4
SEQ = 4096
DEPTH = 4

CHUNK = 64
N_MIXERS = 3
CONV_A_WIDTH = 31
CONV_C_WIDTH = 3
SGU_BLOCK = 128
SGU_HEADS = 8
SGU_WIDTH = 2 * D_MODEL
SGU_GROUP = SGU_WIDTH // SGU_HEADS
D_FF = -(-8 * D_MODEL // (3 * 256)) * 256
D_PLE = 256
ALPHA = (2 * DEPTH) ** 0.25
BETA = (8 * DEPTH) ** -0.25
LN_EPS = 1e-5
N_A = (DEPTH + 2) // 3
N_B = (DEPTH + 1) // 3
N_C = DEPTH // 3

kernel_name = "interleaved_conv_sgu_shortconv_deepnorm_trunk"


def layer_norm(x, g, b):
    xf = x.astype(jnp.float32)
    mu = jnp.mean(xf, axis=-1, keepdims=True)
    xc = xf - mu
    var = jnp.mean(xc * xc, axis=-1, keepdims=True)
    y = xc * lax.rsqrt(var + LN_EPS) * g.astype(jnp.float32) + b.astype(jnp.float32)
    return y.astype(x.dtype)


def rms_norm(x, g):
    xf = x.astype(jnp.float32)
    y = xf * lax.rsqrt(jnp.mean(xf * xf, axis=-1, keepdims=True) + LN_EPS) * g.astype(jnp.float32)
    return y.astype(x.dtype)


def causal_depthwise_conv(x, w):
    k, c = w.shape
    return lax.conv_general_dilated(
        x, w[:, None, :].astype(x.dtype), window_strides=(1,), padding=[(k - 1, 0)],
        dimension_numbers=("NWC", "WIO", "NWC"), feature_group_count=c)


def mixer_conformer_conv(x, w_pw1, b_pw1, w_dw, b_dw, ln_g, ln_b, w_pw2):
    h = x @ w_pw1 + b_pw1
    a, g = jnp.split(h, 2, axis=-1)
    h = a * jax.nn.sigmoid(g)
    h = causal_depthwise_conv(h, w_dw) + b_dw
    h = jax.nn.silu(layer_norm(h, ln_g, ln_b))
    return h @ w_pw2


def mixer_sgu(x, w_in, b_in, ln_g, ln_b, w_s, b_s, w_out):
    bsz, seq, _ = x.shape
    z = jax.nn.gelu(x @ w_in + b_in)
    u, v = jnp.split(z, 2, axis=-1)
    v = layer_norm(v, ln_g, ln_b)
    v = v.reshape(bsz, seq // SGU_BLOCK, SGU_BLOCK, SGU_HEADS, SGU_GROUP)
    pos = jnp.arange(SGU_BLOCK) // CHUNK
    mask = pos[:, None] >= pos[None, :]
    w_m = jnp.where(mask[None], w_s, jnp.zeros_like(w_s))
    f = jnp.einsum("hts,bnshg->bnthg", w_m, v) + jnp.transpose(b_s)[None, None, :, :, None]
    return (u * f.reshape(bsz, seq, SGU_WIDTH)) @ w_out


def mixer_short_conv(x, w_in, w_conv, w_out):
    bg, cg, h = jnp.split(x @ w_in, 3, axis=-1)
    y = causal_depthwise_conv(cg * h, w_conv)
    return (bg * y) @ w_out


def swiglu(x, w_gate, w_up, w_down):
    return (jax.nn.silu(x @ w_gate) * (x @ w_up)) @ w_down


def setup_inputs(seed: int = 0) -> dict:
    key = jax.random.key(seed)
    ks = jax.random.split(key, 32)
    f32 = jnp.float32

    def nrm(k, shape, scale):
        return jax.random.normal(k, shape, f32) * scale

    D, E = D_MODEL, SGU_WIDTH
    return {
        "x": nrm(ks[0], (BATCH, SEQ, D), 1.0),
        "p": nrm(ks[1], (DEPTH, BATCH, SEQ, D_PLE), 1.0),
        "a_w_pw1": nrm(ks[2], (N_A, D, 2 * D), D ** -0.5),
        "a_b_pw1": nrm(ks[3], (N_A, 2 * D), 0.02),
        "a_w_dw": nrm(ks[4], (N_A, CONV_A_WIDTH, D), CONV_A_WIDTH ** -0.5),
        "a_b_dw": nrm(ks[5], (N_A, D), 0.02),
        "a_ln_g": 1.0 + nrm(ks[6], (N_A, D), 0.02),
        "a_ln_b": nrm(ks[7], (N_A, D), 0.02),
        "a_w_pw2": nrm(ks[8], (N_A, D, D), BETA * D ** -0.5),
        "b_w_in": nrm(ks[9], (N_B, D, 2 * E), D ** -0.5),
        "b_b_in": nrm(ks[10], (N_B, 2 * E), 0.02),
        "b_ln_g": 1.0 + nrm(ks[11], (N_B, E), 0.02),
        "b_ln_b": nrm(ks[12], (N_B, E), 0.02),
        "b_w_s": nrm(ks[13], (N_B, SGU_HEADS, SGU_BLOCK, SGU_BLOCK), SGU_BLOCK ** -0.5),
        "b_b_s": 1.0 + nrm(ks[14], (N_B, SGU_HEADS, SGU_BLOCK), 0.02),
        "b_w_out": nrm(ks[15], (N_B, E, D), BETA * E ** -0.5),
        "c_w_in": nrm(ks[16], (N_C, D, 3 * D), D ** -0.5),
        "c_w_conv": nrm(ks[17], (N_C, CONV_C_WIDTH, D), CONV_C_WIDTH ** -0.5),
        "c_w_out": nrm(ks[18], (N_C, D, D), BETA * D ** -0.5),
        "ln1_g": 1.0 + nrm(ks[19], (DEPTH, D), 0.02),
        "ln1_b": nrm(ks[20], (DEPTH, D), 0.02),
        "ln2_g": 1.0 + nrm(ks[21], (DEPTH, D), 0.02),
        "ln2_b": nrm(ks[22], (DEPTH, D), 0.02),
        "ffn_w_gate": nrm(ks[23], (DEPTH, D, D_FF), D ** -0.5),
        "ffn_w_up": nrm(ks[24], (DEPTH, D, D_FF), D ** -0.5),
        "ffn_w_down": nrm(ks[25], (DEPTH, D_FF, D), BETA * D_FF ** -0.5),
        "ple_w_gate": nrm(ks[26], (DEPTH, D, D), D ** -0.5),
        "ple_w_proj": nrm(ks[27], (DEPTH, D_PLE, D), D_PLE ** -0.5),
        "ple_norm_g": 1.0 + nrm(ks[28], (DEPTH, D), 0.02),
    }


def reference(x, p,
              a_w_pw1, a_b_pw1, a_w_dw, a_b_dw, a_ln_g, a_ln_b, a_w_pw2,
              b_w_in, b_b_in, b_ln_g, b_ln_b, b_w_s, b_b_s, b_w_out,
              c_w_in, c_w_conv, c_w_out,
              ln1_g, ln1_b, ln2_g, ln2_b,
              ffn_w_gate, ffn_w_up, ffn_w_down,
              ple_w_gate, ple_w_proj, ple_norm_g):
    for i in range(DEPTH):
        m, j = i % N_MIXERS, i // N_MIXERS
        if m == 0:
            h = mixer_conformer_conv(x, a_w_pw1[j], a_b_pw1[j], a_w_dw[j], a_b_dw[j],
                                     a_ln_g[j], a_ln_b[j], a_w_pw2[j])
        elif m == 1:
            h = mixer_sgu(x, b_w_in[j], b_b_in[j], b_ln_g[j], b_ln_b[j],
                          b_w_s[j], b_b_s[j], b_w_out[j])
        else:
            h = mixer_short_conv(x, c_w_in[j], c_w_conv[j], c_w_out[j])
        x = layer_norm(ALPHA * x + h, ln1_g[i], ln1_b[i])
        x = layer_norm(ALPHA * x + swiglu(x, ffn_w_gate[i], ffn_w_up[i], ffn_w_down[i]),
                       ln2_g[i], ln2_b[i])
        gate = jax.nn.sigmoid(x @ ple_w_gate[i])
        x = x + gate * rms_norm(p[i] @ ple_w_proj[i], ple_norm_g[i])
    return x
```

```cpp
#include <hip/hip_runtime.h>
#include <cstdio>
#include <cstdint>

typedef unsigned short bf16_t;
typedef short bf16x8 __attribute__((ext_vector_type(8)));
typedef float f32x4 __attribute__((ext_vector_type(4)));

constexpr int D = 1024, BATCH = 4, SEQ = 4096, M = BATCH * SEQ, DEPTH = 4;
constexpr int DFF = 2816, DPLE = 256, E2 = 2048;
constexpr float ALPHA = 1.681792830507429f;
constexpr float LN_EPS = 1e-5f;

__device__ __forceinline__ unsigned f2bf(float f) { unsigned u = __builtin_bit_cast(unsigned, f); return (u + 0x7fffu + ((u >> 16) & 1u)) >> 16; }
__device__ __forceinline__ float bf2f(bf16_t b) { return __builtin_bit_cast(float, ((unsigned)b) << 16); }
__device__ __forceinline__ float sigmoidf_(float x) { return 1.f / (1.f + __expf(-x)); }
__device__ __forceinline__ float siluf_(float x) { return x * sigmoidf_(x); }
__device__ __forceinline__ float gelu_tanh(float x) { const float u = 0.7978845608028654f * (x + 0.044715f * x * x * x); return 0.5f * x * (1.f + tanhf(u)); }
__device__ __forceinline__ float wave_sum(float v) {
#pragma unroll
    for (int o = 1; o < 64; o <<= 1) v += __shfl_xor(v, o);
    return v;
}

__global__ void k_cvt(const float* __restrict__ in, bf16_t* __restrict__ out, size_t n) {
    for (size_t i = (size_t)blockIdx.x * blockDim.x + threadIdx.x; i < n; i += (size_t)gridDim.x * blockDim.x) out[i] = (bf16_t)f2bf(in[i]);
}

template <int NACC, class Epi>
__global__ __launch_bounds__(256) void k_gemm(const bf16_t* __restrict__ A, const float* __restrict__ W0, const float* __restrict__ W1, int lda, int ldw, int K, int pad_, Epi E) {
    __shared__ __attribute__((aligned(16))) bf16_t sA[64][40];
    __shared__ __attribute__((aligned(16))) bf16_t sB[NACC][64][40];
    const int tid = threadIdx.x, lane = tid & 63, wid = tid >> 6, fr = lane & 15, fq = lane >> 4;
    const int row0 = blockIdx.y * 64, col0 = blockIdx.x * 64;
    f32x4 acc[NACC][4];
#pragma unroll
    for (int a = 0; a < NACC; ++a)
#pragma unroll
        for (int n = 0; n < 4; ++n) acc[a][n] = (f32x4){0.f, 0.f, 0.f, 0.f};
    for (int k0 = 0; k0 < K; k0 += 32) {
        {
            const int r = tid >> 2, c = (tid & 3) * 8;
            *(uint4*)&sA[r][c] = *(const uint4*)(A + (size_t)(row0 + r) * lda + k0 + c);
        }
#pragma unroll
        for (int a = 0; a < NACC; ++a) {
            const float* W = a == 0 ? W0 : W1;
            const int k = tid >> 3, n = (tid & 7) * 8;
            const float4 w0 = *(const float4*)(W + (size_t)(k0 + k) * ldw + col0 + n), w1 = *(const float4*)(W + (size_t)(k0 + k) * ldw + col0 + n + 4);
            sB[a][n + 0][k] = (bf16_t)f2bf(w0.x); sB[a][n + 1][k] = (bf16_t)f2bf(w0.y); sB[a][n + 2][k] = (bf16_t)f2bf(w0.z); sB[a][n + 3][k] = (bf16_t)f2bf(w0.w);
            sB[a][n + 4][k] = (bf16_t)f2bf(w1.x); sB[a][n + 5][k] = (bf16_t)f2bf(w1.y); sB[a][n + 6][k] = (bf16_t)f2bf(w1.z); sB[a][n + 7][k] = (bf16_t)f2bf(w1.w);
        }
        __syncthreads();
        const bf16x8 af = *(const bf16x8*)&sA[wid * 16 + fr][fq * 8];
#pragma unroll
        for (int a = 0; a < NACC; ++a)
#pragma unroll
            for (int n = 0; n < 4; ++n) { const bf16x8 bfr = *(const bf16x8*)&sB[a][n * 16 + fr][fq * 8]; acc[a][n] = __builtin_amdgcn_mfma_f32_16x16x32_bf16(af, bfr, acc[a][n], 0, 0, 0); }
        __syncthreads();
    }
#pragma unroll
    for (int n = 0; n < 4; ++n)
#pragma unroll
        for (int j = 0; j < 4; ++j) { const int r = row0 + wid * 16 + fq * 4 + j, c = col0 + n * 16 + fr; E(r, c, acc[0][n][j], NACC > 1 ? acc[NACC - 1][n][j] : 0.f); }
}

struct EpiGLU { bf16_t* out; long ldo; const float* b0; const float* b1; __device__ void operator()(int r, int c, float a, float g) const { out[(size_t)r * ldo + c] = (bf16_t)f2bf((a + b0[c]) * sigmoidf_(g + b1[c])); } };
struct EpiSwiGLU { bf16_t* out; long ldo; __device__ void operator()(int r, int c, float g, float u) const { out[(size_t)r * ldo + c] = (bf16_t)f2bf(siluf_(g) * u); } };
struct EpiMul { bf16_t* out; long ldo; __device__ void operator()(int r, int c, float a, float b) const { out[(size_t)r * ldo + c] = (bf16_t)f2bf(a * b); } };
struct EpiBf { bf16_t* out; long ldo; __device__ void operator()(int r, int c, float a, float) const { out[(size_t)r * ldo + c] = (bf16_t)f2bf(a); } };
struct EpiGelu { bf16_t* out; long ldo; const float* b; __device__ void operator()(int r, int c, float a, float) const { out[(size_t)r * ldo + c] = (bf16_t)f2bf(gelu_tanh(a + b[c])); } };
struct EpiResid { float* y; const float* xold; __device__ void operator()(int r, int c, float a, float) const { y[(size_t)r * D + c] = ALPHA * xold[(size_t)r * D + c] + a; } };
struct EpiSig { float* out; __device__ void operator()(int r, int c, float a, float) const { out[(size_t)r * D + c] = sigmoidf_(a); } };
struct EpiF32 { float* out; __device__ void operator()(int r, int c, float a, float) const { out[(size_t)r * D + c] = a; } };

__global__ __launch_bounds__(256) void k_ln(const float* __restrict__ y, const float* __restrict__ g, const float* __restrict__ b, float* __restrict__ x, bf16_t* __restrict__ xb) {
    const int row = blockIdx.x * 4 + (threadIdx.x >> 6), lane = threadIdx.x & 63;
    const float* yr = y + (size_t)row * D; float v[16]; float s = 0.f;
#pragma unroll
    for (int j = 0; j < 16; ++j) { v[j] = yr[lane + 64 * j]; s += v[j]; }
    const float mean = wave_sum(s) * (1.f / D); float q = 0.f;
#pragma unroll
    for (int j = 0; j < 16; ++j) { v[j] -= mean; q += v[j] * v[j]; }
    const float rstd = rsqrtf(wave_sum(q) * (1.f / D) + LN_EPS);
#pragma unroll
    for (int j = 0; j < 16; ++j) { const int c = lane + 64 * j; const float o = v[j] * rstd * g[c] + b[c]; x[(size_t)row * D + c] = o; xb[(size_t)row * D + c] = (bf16_t)f2bf(o); }
}

__global__ __launch_bounds__(256) void k_conv31(const bf16_t* __restrict__ h1, const float* __restrict__ wdw, const float* __restrict__ bdw, const float* __restrict__ g, const float* __restrict__ b, bf16_t* __restrict__ h2) {
    const int row = blockIdx.x * 4 + (threadIdx.x >> 6), lane = threadIdx.x & 63, t = row % SEQ;
    float v[16]; float s = 0.f;
#pragma unroll
    for (int j = 0; j < 16; ++j) { const int c = lane + 64 * j; float a = bdw[c];
        for (int k = 0; k < 31; ++k) { const int tt = t - 30 + k; if (tt >= 0) a += wdw[k * D + c] * bf2f(h1[(size_t)(row - 30 + k) * D + c]); }
        v[j] = a; s += a; }
    const float mean = wave_sum(s) * (1.f / D); float q = 0.f;
#pragma unroll
    for (int j = 0; j < 16; ++j) { v[j] -= mean; q += v[j] * v[j]; }
    const float rstd = rsqrtf(wave_sum(q) * (1.f / D) + LN_EPS);
#pragma unroll
    for (int j = 0; j < 16; ++j) { const int c = lane + 64 * j; h2[(size_t)row * D + c] = (bf16_t)f2bf(siluf_(v[j] * rstd * g[c] + b[c])); }
}

__global__ __launch_bounds__(256) void k_ln_v(bf16_t* __restrict__ v, const float* __restrict__ g, const float* __restrict__ b) {
    const int row = blockIdx.x * 4 + (threadIdx.x >> 6), lane = threadIdx.x & 63;
    bf16_t* vr = v + (size_t)row * E2; float x[32]; float s = 0.f;
#pragma unroll
    for (int j = 0; j < 32; ++j) { x[j] = bf2f(vr[lane + 64 * j]); s += x[j]; }
    const float mean = wave_sum(s) * (1.f / E2); float q = 0.f;
#pragma unroll
    for (int j = 0; j < 32; ++j) { x[j] -= mean; q += x[j] * x[j]; }
    const float rstd = rsqrtf(wave_sum(q) * (1.f / E2) + LN_EPS);
#pragma unroll
    for (int j = 0; j < 32; ++j) { const int c = lane + 64 * j; vr[c] = (bf16_t)f2bf(x[j] * rstd * g[c] + b[c]); }
}
__global__ __launch_bounds__(256) void k_sgu(bf16_t* __restrict__ u, const bf16_t* __restrict__ v, const float* __restrict__ ws, const float* __restrict__ bs) {
    __shared__ float sv[128][64];
    const int n = blockIdx.x, h = blockIdx.y >> 2, slab = blockIdx.y & 3, c = threadIdx.x & 63, tq = threadIdx.x >> 6;
    const int ch = h * 256 + slab * 64 + c;
    for (int s = tq; s < 128; s += 4) sv[s][c] = bf2f(v[(size_t)(n * 128 + s) * E2 + ch]);
    __syncthreads();
    const float* w = ws + (size_t)h * 128 * 128;
    for (int t = tq; t < 128; t += 4) {
        const int smax = t < 64 ? 64 : 128; float a = bs[h * 128 + t];
        for (int s = 0; s < smax; ++s) a += bf2f((bf16_t)f2bf(w[t * 128 + s])) * sv[s][c];
        const size_t o = (size_t)(n * 128 + t) * E2 + ch; u[o] = (bf16_t)f2bf(bf2f(u[o]) * a);
    }
}

__global__ void k_conv3(const bf16_t* __restrict__ bg, const bf16_t* __restrict__ chb, const float* __restrict__ wc, bf16_t* __restrict__ yb) {
    const size_t i = (size_t)blockIdx.x * blockDim.x + threadIdx.x; const int row = (int)(i / D), c = (int)(i % D), t = row % SEQ;
    float a = 0.f;
    for (int k = 0; k < 3; ++k) { const int tt = t - 2 + k; if (tt >= 0) a += wc[k * D + c] * bf2f(chb[(size_t)(row - 2 + k) * D + c]); }
    yb[i] = (bf16_t)f2bf(bf2f(bg[i]) * a);
}

__global__ __launch_bounds__(256) void k_ple(const float* __restrict__ xin, const float* __restrict__ gate, const float* __restrict__ e, const float* __restrict__ g, float* __restrict__ x, bf16_t* __restrict__ xb) {
    const int row = blockIdx.x * 4 + (threadIdx.x >> 6), lane = threadIdx.x & 63;
    float v[16]; float q = 0.f;
#pragma unroll
    for (int j = 0; j < 16; ++j) { v[j] = e[(size_t)row * D + lane + 64 * j]; q += v[j] * v[j]; }
    const float rstd = rsqrtf(wave_sum(q) * (1.f / D) + LN_EPS);
#pragma unroll
    for (int j = 0; j < 16; ++j) { const int c = lane + 64 * j; const size_t o = (size_t)row * D + c; const float r = xin[o] + gate[o] * v[j] * rstd * g[c]; x[o] = r; xb[o] = (bf16_t)f2bf(r); }
}

template <int NACC, class Epi> static void gemm(hipStream_t st, const bf16_t* A, int lda, const float* W0, const float* W1, int ldw, int K, int N, const Epi& E) {
    hipLaunchKernelGGL((k_gemm<NACC, Epi>), dim3(N / 64, M / 64), dim3(256), 0, st, A, W0, W1, lda, ldw, K, 0, E);
}

extern "C" void kernel_launch(void* const* d_in, const int* in_sizes, int n_in, void* d_out, int out_size, void* d_ws, size_t ws_size, hipStream_t st) {
    constexpr size_t MiB = 1u << 20;
    constexpr size_t WS_XB = 0, WS_Y = 32 * MiB, WS_PB = 96 * MiB, WS_S = 128 * MiB, WS_END = 256 * MiB;
    if (n_in != 29 || out_size != M * D || ws_size < WS_END) { fprintf(stderr, "kernel_launch: unexpected sizes\n"); return; }
    const float* const* in = (const float* const*)d_in;
    const float* x0 = in[0]; const float* p = in[1];
    unsigned char* ws = (unsigned char*)d_ws;
    bf16_t* xb = (bf16_t*)(ws + WS_XB); float* ybuf = (float*)(ws + WS_Y); bf16_t* pb = (bf16_t*)(ws + WS_PB); unsigned char* S = ws + WS_S;
    float* xo = (float*)d_out;
    hipLaunchKernelGGL(k_cvt, dim3(2048), dim3(256), 0, st, x0, xb, (size_t)M * D);
    hipLaunchKernelGGL(k_cvt, dim3(2048), dim3(256), 0, st, p, pb, (size_t)DEPTH * M * DPLE);
    const float* xcur = x0;
    for (int i = 0; i < DEPTH; ++i) {
        const int m = i % 3, j = i / 3;
        const float* wout; int kout; const bf16_t* aout;
        if (m == 0) {
            bf16_t* h1 = (bf16_t*)S; bf16_t* h2 = (bf16_t*)(S + 32 * MiB);
            const float* w1 = in[2] + (size_t)j * D * 2 * D; const float* b1 = in[3] + (size_t)j * 2 * D;
            gemm<2>(st, xb, D, w1, w1 + D, 2 * D, D, D, EpiGLU{h1, D, b1, b1 + D});
            hipLaunchKernelGGL(k_conv31, dim3(M / 4), dim3(256), 0, st, h1, in[4] + (size_t)j * 31 * D, in[5] + (size_t)j * D, in[6] + (size_t)j * D, in[7] + (size_t)j * D, h2);
            wout = in[8] + (size_t)j * D * D; kout = D; aout = h2;
        } else if (m == 1) {
            bf16_t* u = (bf16_t*)S; bf16_t* v = (bf16_t*)(S + 64 * MiB);
            gemm<1>(st, xb, D, in[9], nullptr, 2 * E2, D, E2, EpiGelu{u, E2, in[10]});
            gemm<1>(st, xb, D, in[9] + E2, nullptr, 2 * E2, D, E2, EpiGelu{v, E2, in[10] + E2});
            hipLaunchKernelGGL(k_ln_v, dim3(M / 4), dim3(256), 0, st, v, in[11], in[12]);
            hipLaunchKernelGGL(k_sgu, dim3(M / 128, 32), dim3(256), 0, st, u, v, in[13], in[14]);
            wout = in[15]; kout = E2; aout = u;
        } else {
            bf16_t* bg = (bf16_t*)S; bf16_t* chb = (bf16_t*)(S + 32 * MiB); bf16_t* yb = (bf16_t*)(S + 64 * MiB);
            gemm<1>(st, xb, D, in[16], nullptr, 3 * D, D, D, EpiBf{bg, D});
            gemm<2>(st, xb, D, in[16] + D, in[16] + 2 * D, 3 * D, D, D, EpiMul{chb, D});
            hipLaunchKernelGGL(k_conv3, dim3(M * D / 256), dim3(256), 0, st, bg, chb, in[17], yb);
            wout = in[18]; kout = D; aout = yb;
        }
        gemm<1>(st, aout, kout, wout, nullptr, D, kout, D, EpiResid{ybuf, xcur});
        hipLaunchKernelGGL(k_ln, dim3(M / 4), dim3(256), 0, st, ybuf, in[19] + (size_t)i * D, in[20] + (size_t)i * D, xo, xb);
        xcur = xo;
        bf16_t* hf = (bf16_t*)S;
        gemm<2>(st, xb, D, in[23] + (size_t)i * D * DFF, in[24] + (size_t)i * D * DFF, DFF, D, DFF, EpiSwiGLU{hf, DFF});
        gemm<1>(st, hf, DFF, in[25] + (size_t)i * DFF * D, nullptr, D, DFF, D, EpiResid{ybuf, xcur});
        hipLaunchKernelGGL(k_ln, dim3(M / 4), dim3(256), 0, st, ybuf, in[21] + (size_t)i * D, in[22] + (size_t)i * D, xo, xb);
        float* gate = (float*)S; float* e = (float*)(S + 64 * MiB);
        gemm<1>(st, xb, D, in[26] + (size_t)i * D * D, nullptr, D, D, D, EpiSig{gate});
        gemm<1>(st, pb + (size_t)i * M * DPLE, DPLE, in[27] + (size_t)i * DPLE * D, nullptr, D, DPLE, D, EpiF32{e});
        hipLaunchKernelGGL(k_ple, dim3(M / 4), dim3(256), 0, st, xo, gate, e, in[28] + (size_t)i * D, xo, xb);
    }
}
```
